# Optimizing an MI355X kernel written in HIP

```python
import math
import jax, jax.numpy as jnp
from jax import lax
import numpy as np

D_MODEL = 1024
BATCH = 4
SEQ = 8192
DEPTH = 1

N_META = 16
BLOCK = 128
WINDOW = 128
N_Q_HEADS = 16
N_KV_HEADS = 4
HEAD_DIM = 64
Q_GROUP = N_Q_HEADS // N_KV_HEADS
Q_WIDTH = N_Q_HEADS * HEAD_DIM
KV_WIDTH = N_KV_HEADS * HEAD_DIM
POOL_WINDOWS = (2, 4, 8, 16)
N_POOL_GROUPS = 4
POOL_WIDTH = D_MODEL
POOL_GROUP = POOL_WIDTH // N_POOL_GROUPS
N_BRANCHES = 2
IN_WIDTH = POOL_WIDTH + Q_WIDTH + 2 * KV_WIDTH + N_BRANCHES * D_MODEL
D_FF = 4 * D_MODEL
N_BUCKETS = 32
MAX_DISTANCE = 128
RMS_EPS = 1e-5

kernel_name = "hybrid_pool_swa_gated_block"


def rms_norm(x, g):
    xf = x.astype(jnp.float32)
    y = xf * lax.rsqrt(jnp.mean(xf * xf, axis=-1, keepdims=True) + RMS_EPS)
    return (y * g.astype(jnp.float32)).astype(x.dtype)


def t5_causal_bucket(dist):
    n = jnp.maximum(dist, 0)
    max_exact = N_BUCKETS // 2
    nf = jnp.maximum(n, 1).astype(jnp.float32)
    large = max_exact + (jnp.log(nf / max_exact) / math.log(MAX_DISTANCE / max_exact)
                         * (N_BUCKETS - max_exact)).astype(jnp.int32)
    large = jnp.minimum(large, N_BUCKETS - 1)
    return jnp.where(n < max_exact, n, large)


def multiscale_pool(z):
    B, L, _ = z.shape
    zf = z.astype(jnp.float32).reshape(B, L, N_POOL_GROUPS, POOL_GROUP)
    csum = jnp.pad(jnp.cumsum(zf, axis=1), ((0, 0), (1, 0), (0, 0), (0, 0)))
    t = jnp.arange(L)
    outs = []
    for g, w in enumerate(POOL_WINDOWS):
        end = csum[:, 1:, g]
        prev = jnp.pad(csum[:, :L + 1 - w, g], ((0, 0), (w - 1, 0), (0, 0)))
        cnt = jnp.minimum(t + 1, w).astype(jnp.float32)
        outs.append((end - prev) / cnt[None, :, None])
    pooled = jnp.stack(outs, axis=2)
    return (pooled - zf).astype(z.dtype)


def sliding_window_attention(q, k, v, sinks, rel_bias):
    B, L = q.shape[:2]
    pad = BLOCK - N_META
    padf = lambda a: jnp.pad(a, ((0, 0), (pad, 0), (0, 0), (0, 0)))
    qp, kp, vp = padf(q), padf(k), padf(v)
    NB = (L + pad) // BLOCK
    NK = N_META + 2 * BLOCK
    qb = qp.reshape(B, NB, BLOCK, N_KV_HEADS, Q_GROUP, HEAD_DIM)

    def band(a):
        ab = a.reshape(B, NB, BLOCK, N_KV_HEADS, HEAD_DIM)
        prev = jnp.pad(ab[:, :-1], ((0, 0), (1, 0), (0, 0), (0, 0), (0, 0)))
        meta = jnp.broadcast_to(a[:, pad:pad + N_META][:, None],
                                (B, NB, N_META, N_KV_HEADS, HEAD_DIM))
        return jnp.concatenate([meta, prev, ab], axis=2)

    kb, vb = band(kp), band(vp)

    meta_pos = pad + jnp.arange(N_META)
    band_pos = (jnp.arange(NB)[:, None] - 1) * BLOCK + jnp.arange(2 * BLOCK)[None, :]
    kpos = jnp.concatenate([jnp.broadcast_to(meta_pos[None], (NB, N_META)), band_pos], axis=1)
    qpos = jnp.arange(NB)[:, None] * BLOCK + jnp.arange(BLOCK)[None, :]
    dist = qpos[:, :, None] - kpos[:, None, :]
    is_meta = jnp.arange(NK) < N_META
    valid = (dist >= 0) & (is_meta[None, None, :]
                           | ((kpos[:, None, :] >= BLOCK) & (dist < WINDOW)))

    bias = rel_bias.astype(jnp.float32)[t5_causal_bucket(dist)]
    bias = bias.reshape(NB, BLOCK, NK, N_KV_HEADS, Q_GROUP).transpose(0, 3, 4, 1, 2)

    scale = HEAD_DIM ** -0.5
    s = jnp.einsum("bnqhgd,bnkhd->bnhgqk", qb, kb).astype(jnp.float32) * scale + bias[None]
    s = jnp.where(valid[None, :, None, None], s, -jnp.inf)
    sink = sinks.astype(jnp.float32).reshape(N_KV_HEADS, Q_GROUP)[None, None, :, :, None, None]
    m = jnp.maximum(jnp.max(s, axis=-1, keepdims=True), sink)
    p = jnp.exp(s - m)
    probs = p / (jnp.sum(p, axis=-1, keepdims=True) + jnp.exp(sink - m))
    o = jnp.einsum("bnhgqk,bnkhd->bnqhgd", probs.astype(vb.dtype), vb)
    return o.reshape(B, NB * BLOCK, Q_WIDTH)[:, pad:]


def hybrid_layer(h, rel_bias, norm_mix_g, w_in, pool_w, pool_scale, w_pool_br, sinks,
                 w_attn_br, w_out, norm_mlp_g, w_up, w_down):
    B, L, _ = h.shape
    u = rms_norm(h, norm_mix_g)
    z = u @ w_in
    o1 = POOL_WIDTH
    o2 = o1 + Q_WIDTH
    o3 = o2 + KV_WIDTH
    o4 = o3 + KV_WIDTH
    o5 = o4 + D_MODEL
    z_pool, z_q, z_k, z_v, z_gp, z_ga = jnp.split(z, [o1, o2, o3, o4, o5], axis=-1)

    pooled = multiscale_pool(z_pool)
    mixed = jnp.einsum("blgc,gcd->blgd", pooled, pool_w).reshape(B, L, POOL_WIDTH)
    y_pool = (mixed * pool_scale) @ w_pool_br

    q = z_q.reshape(B, L, N_Q_HEADS, HEAD_DIM)
    k = z_k.reshape(B, L, N_KV_HEADS, HEAD_DIM)
    v = z_v.reshape(B, L, N_KV_HEADS, HEAD_DIM)
    y_attn = sliding_window_attention(q, k, v, sinks, rel_bias) @ w_attn_br

    merged = jax.nn.sigmoid(z_gp) * y_pool + jax.nn.sigmoid(z_ga) * y_attn
    h = h + merged @ w_out

    u2 = rms_norm(h, norm_mlp_g)
    h = h + jnp.square(jax.nn.relu(u2 @ w_up)) @ w_down
    return h


def setup_inputs(seed: int = 0) -> dict:
    key = jax.random.key(seed)
    ks = jax.random.split(key, 16)
    f32 = jnp.float32
    nrm = lambda k, shape, s: jax.random.normal(k, shape, f32) * s
    return {
        "x": nrm(ks[0], (BATCH, SEQ, D_MODEL), 1.0),
        "meta_tokens": nrm(ks[1], (N_META, D_MODEL), 1.0),
        "rel_bias": nrm(ks[2], (N_BUCKETS, N_Q_HEADS), 0.5),
        "norm_mix_g": 1.0 + nrm(ks[3], (DEPTH, D_MODEL), 0.02),
        "w_in": nrm(ks[4], (DEPTH, D_MODEL, IN_WIDTH), D_MODEL ** -0.5),
        "pool_w": nrm(ks[5], (DEPTH, N_POOL_GROUPS, POOL_GROUP, POOL_GROUP), POOL_GROUP ** -0.5),
        "pool_scale": 1.0 + nrm(ks[6], (DEPTH, POOL_WIDTH), 0.02),
        "w_pool_br": nrm(ks[7], (DEPTH, POOL_WIDTH, D_MODEL), POOL_WIDTH ** -0.5),
        "sinks": nrm(ks[8], (DEPTH, N_Q_HEADS), 0.5),
        "w_attn_br": nrm(ks[9], (DEPTH, Q_WIDTH, D_MODEL), Q_WIDTH ** -0.5),
        "w_out": nrm(ks[10], (DEPTH, D_MODEL, D_MODEL), D_MODEL ** -0.5),
        "norm_mlp_g": 1.0 + nrm(ks[11], (DEPTH, D_MODEL), 0.02),
        "w_up": nrm(ks[12], (DEPTH, D_MODEL, D_FF), D_MODEL ** -0.5),
        "w_down": nrm(ks[13], (DEPTH, D_FF, D_MODEL), D_FF ** -0.5),
        "norm_final_g": 1.0 + nrm(ks[14], (D_MODEL,), 0.02),
    }


def reference(x, meta_tokens, rel_bias, norm_mix_g, w_in, pool_w, pool_scale, w_pool_br,
              sinks, w_attn_br, w_out, norm_mlp_g, w_up, w_down, norm_final_g):
    B = x.shape[0]
    meta = jnp.broadcast_to(meta_tokens[None].astype(x.dtype), (B, N_META, D_MODEL))
    h = jnp.concatenate([meta, x], axis=1)
    for l in range(DEPTH):
        h = hybrid_layer(h, rel_bias, norm_mix_g[l], w_in[l], pool_w[l], pool_scale[l],
                         w_pool_br[l], sinks[l], w_attn_br[l], w_out[l], norm_mlp_g[l],
                         w_up[l], w_down[l])
    h = rms_norm(h, norm_final_g)
    return h[:, N_META:]
```

```cpp
#include <hip/hip_runtime.h>
#include <cstdio>
#include <cstdint>

#ifndef MK_N_LAUNCHES
#define MK_N_LAUNCHES 1
#endif

namespace pg8 {
#define PG8_LAS __attribute__((address_space(3)))
typedef unsigned short bf16_t;
typedef short bf16x8 __attribute__((ext_vector_type(8)));
typedef float f32x4 __attribute__((ext_vector_type(4)));
typedef float f32x2 __attribute__((ext_vector_type(2)));
typedef unsigned u32x4 __attribute__((ext_vector_type(4)));
typedef unsigned u32x2 __attribute__((ext_vector_type(2)));
constexpr int BM = 256, BK = 64, HALF = 128, HTB = HALF * BK * 2  , STAGE_BYTES = 8 * HTB, NXCD = 8, WGM = 8;

__host__ __device__ __forceinline__ int lds_byte(int r, int c) { const int st = (r >> 4) * 2 + (c >> 5), rr = r & 15, cc = c & 31, ob = rr * 64 + cc * 2; return st * 1024 + (ob ^ (((ob >> 9) & 1) << 5)); }
__host__ __device__ __forceinline__ void stage_rc(int b, int& R, int& C) { const int st = b / 1024, sb = b % 1024, swz = sb ^ (((sb >> 9) & 1) << 5); R = (st >> 1) * 16 + swz / 64; C = (st & 1) * 32 + (swz % 64) / 2; }
__host__ __device__ __forceinline__ int perm32(int rho) { const int n = rho >> 4, i = rho & 15; return 8 * (i >> 2) + 4 * n + (i & 3); }

struct Unit { int pm, pn, z, idx; };
struct Gemm { const bf16_t* A0; const bf16_t* A1; const bf16_t* B0; const bf16_t* B1; int lda, ldb, K, a_pn_step; };

struct StaticOrder {
    int nM, nN, nwg, G, c, nz;
    __host__ __device__ void init(int M, int N, int G_, int c_, int nz_ = 1) { nM = M / BM; nN = N / BM; nwg = nM * nN; G = G_; c = c_; nz = nz_; }
    __host__ __device__ bool next(int i, Unit& u) const {
        const int ib = (nz == 2) ? (i >> 1) : i;
        const long L = (long)ib * G + c; if (L >= nwg) return false;
        int wgid = (int)L; { const int q = nwg / NXCD, r = nwg % NXCD, xcd = wgid % NXCD, off = wgid / NXCD; wgid = (xcd < r ? xcd * (q + 1) : r * (q + 1) + (xcd - r) * q) + off; }
        const int nig = WGM * nN, gid = wgid / nig, fm = gid * WGM, gsz = (nM - fm) < WGM ? (nM - fm) : WGM;
        u.pm = fm + ((wgid % nig) % gsz); u.pn = (wgid % nig) / gsz; u.z = (nz == 2) ? (i & 1) : 0; u.idx = i; return true;
    }
};

__device__ __forceinline__ unsigned cvt_pk_bf16(float lo, float hi) { unsigned r; asm volatile("v_cvt_pk_bf16_f32 %0, %1, %2" : "=v"(r) : "v"(lo), "v"(hi)); return r; }
__device__ __forceinline__ float bf_lo(unsigned w) { return __builtin_bit_cast(float, w << 16); }
__device__ __forceinline__ float bf_hi(unsigned w) { return __builtin_bit_cast(float, w & 0xffff0000u); }
__device__ __forceinline__ float sigmoid_f(float x) { return __builtin_amdgcn_rcpf(1.0f + __builtin_amdgcn_exp2f(-1.4426950408889634f * x)); }


struct EpiInProj {
    static constexpr bool PERM = true;
    bf16_t *ZP, *Q, *Kb, *Vb, *GP, *GA; float qscale;
    __device__ __forceinline__ void operator()(const f32x4 (&acc)[2][2][4][2], const Unit& u, int wr, int wc, int fr, int fq) const {
        const int pn = u.pn; bf16_t* base; int ldc, colt, mode;
        if (pn < 4)       { base = ZP; ldc = 1024; colt = pn * 256; mode = 0; }
        else if (pn < 8)  { base = Q;  ldc = 1024; colt = (pn - 4) * 256; mode = 1; }
        else if (pn == 8) { base = Kb; ldc = 256;  colt = 0; mode = 0; }
        else if (pn == 9) { base = Vb; ldc = 256;  colt = 0; mode = 0; }
        else if (pn < 14) { base = GP; ldc = 1024; colt = (pn - 10) * 256; mode = 2; }
        else              { base = GA; ldc = 1024; colt = (pn - 14) * 256; mode = 2; }
        const float sc = (mode == 1) ? qscale : 1.0f;
        const int row0 = u.pm * BM + wr * 64 + fr, col0 = colt + wc * 32 + 8 * fq;
#pragma unroll
        for (int ai = 0; ai < 2; ++ai)
#pragma unroll
            for (int m = 0; m < 4; ++m) { bf16_t* rowp = base + (size_t)(row0 + ai * HALF + m * 16) * ldc + col0;
#pragma unroll
                for (int bj = 0; bj < 2; ++bj) { f32x4 v0 = acc[ai][bj][m][0], v1 = acc[ai][bj][m][1];
                    if (mode == 2) {
#pragma unroll
                        for (int e = 0; e < 4; ++e) { v0[e] = sigmoid_f(v0[e]); v1[e] = sigmoid_f(v1[e]); } }
                    else { v0 = v0 * sc; v1 = v1 * sc; }
                    u32x4 w; w.x = cvt_pk_bf16(v0[0], v0[1]); w.y = cvt_pk_bf16(v0[2], v0[3]); w.z = cvt_pk_bf16(v1[0], v1[1]); w.w = cvt_pk_bf16(v1[2], v1[3]);
                    *(u32x4*)(rowp + bj * HALF) = w; } }
    }
};
struct EpiScaleCol {
    static constexpr bool PERM = true;
    bf16_t* O; const float* scale;
    __device__ __forceinline__ void operator()(const f32x4 (&acc)[2][2][4][2], const Unit& u, int wr, int wc, int fr, int fq) const {
        const int row0 = u.pm * BM + wr * 64 + fr, col0 = u.pn * BM + wc * 32 + 8 * fq;
        f32x4 sv[2][2];
#pragma unroll
        for (int bj = 0; bj < 2; ++bj)
#pragma unroll
            for (int n = 0; n < 2; ++n) sv[bj][n] = *(const f32x4*)(scale + col0 + bj * HALF + 4 * n);
#pragma unroll
        for (int ai = 0; ai < 2; ++ai)
#pragma unroll
            for (int m = 0; m < 4; ++m) { bf16_t* rowp = O + (size_t)(row0 + ai * HALF + m * 16) * 1024 + col0;
#pragma unroll
                for (int bj = 0; bj < 2; ++bj) { const f32x4 v0 = acc[ai][bj][m][0] * sv[bj][0], v1 = acc[ai][bj][m][1] * sv[bj][1];
                    u32x4 w; w.x = cvt_pk_bf16(v0[0], v0[1]); w.y = cvt_pk_bf16(v0[2], v0[3]); w.z = cvt_pk_bf16(v1[0], v1[1]); w.w = cvt_pk_bf16(v1[2], v1[3]);
                    *(u32x4*)(rowp + bj * HALF) = w; } }
    }
};
struct EpiBranch {
    static constexpr bool PERM = true;
    const bf16_t *GP, *GA; bf16_t *T1, *MG;
    __device__ __forceinline__ void operator()(const f32x4 (&acc)[2][2][4][2], const Unit& u, int wr, int wc, int fr, int fq) const {
        const int row0 = u.pm * BM + wr * 64 + fr, col0 = u.pn * BM + wc * 32 + 8 * fq;
        const bf16_t* gate = u.z ? GA : GP; bf16_t* out = u.z ? MG : T1;
#pragma unroll
        for (int ai = 0; ai < 2; ++ai)
#pragma unroll
            for (int m = 0; m < 4; ++m) { const size_t off = (size_t)(row0 + ai * HALF + m * 16) * 1024 + col0;
#pragma unroll
                for (int bj = 0; bj < 2; ++bj) { const u32x4 gw = *(const u32x4*)(gate + off + bj * HALF);
                    f32x4 v0 = acc[ai][bj][m][0], v1 = acc[ai][bj][m][1];
                    v0[0] *= bf_lo(gw.x); v0[1] *= bf_hi(gw.x); v0[2] *= bf_lo(gw.y); v0[3] *= bf_hi(gw.y); v1[0] *= bf_lo(gw.z); v1[1] *= bf_hi(gw.z); v1[2] *= bf_lo(gw.w); v1[3] *= bf_hi(gw.w);
                    if (u.z) { const u32x4 tw = *(const u32x4*)(T1 + off + bj * HALF);
                        v0[0] += bf_lo(tw.x); v0[1] += bf_hi(tw.x); v0[2] += bf_lo(tw.y); v0[3] += bf_hi(tw.y); v1[0] += bf_lo(tw.z); v1[1] += bf_hi(tw.z); v1[2] += bf_lo(tw.w); v1[3] += bf_hi(tw.w); }
                    u32x4 w; w.x = cvt_pk_bf16(v0[0], v0[1]); w.y = cvt_pk_bf16(v0[2], v0[3]); w.z = cvt_pk_bf16(v1[0], v1[1]); w.w = cvt_pk_bf16(v1[2], v1[3]);
                    *(u32x4*)(out + off + bj * HALF) = w; } }
    }
};
struct EpiOutProj {
    static constexpr bool PERM = true;
    const float* X; float* H1; bf16_t* U2; const float* g2; float* PART; int M;
    __device__ __forceinline__ void operator()(const f32x4 (&acc)[2][2][4][2], const Unit& u, int wr, int wc, int fr, int fq) const {
        const int row0 = u.pm * BM + wr * 64 + fr, col0 = u.pn * BM + wc * 32 + 8 * fq;
        f32x4 gv[2][2];
#pragma unroll
        for (int bj = 0; bj < 2; ++bj)
#pragma unroll
            for (int n = 0; n < 2; ++n) gv[bj][n] = *(const f32x4*)(g2 + col0 + bj * HALF + 4 * n);
#pragma unroll
        for (int ai = 0; ai < 2; ++ai)
#pragma unroll
            for (int m = 0; m < 4; ++m) { const int row = row0 + ai * HALF + m * 16; const size_t off = (size_t)row * 1024 + col0; float ss = 0.f;
#pragma unroll
                for (int bj = 0; bj < 2; ++bj) {
                    const f32x4 h0 = acc[ai][bj][m][0] + *(const f32x4*)(X + off + bj * HALF), h1 = acc[ai][bj][m][1] + *(const f32x4*)(X + off + bj * HALF + 4);
                    *(f32x4*)(H1 + off + bj * HALF) = h0; *(f32x4*)(H1 + off + bj * HALF + 4) = h1;
                    ss += (h0[0] * h0[0] + h0[1] * h0[1]) + (h0[2] * h0[2] + h0[3] * h0[3]) + (h1[0] * h1[0] + h1[1] * h1[1]) + (h1[2] * h1[2] + h1[3] * h1[3]);
                    const f32x4 a = h0 * gv[bj][0], b = h1 * gv[bj][1];
                    u32x4 w; w.x = cvt_pk_bf16(a[0], a[1]); w.y = cvt_pk_bf16(a[2], a[3]); w.z = cvt_pk_bf16(b[0], b[1]); w.w = cvt_pk_bf16(b[2], b[3]);
                    *(u32x4*)(U2 + off + bj * HALF) = w; }
                ss += __shfl_xor(ss, 16); ss += __shfl_xor(ss, 32);
                if (fq == 0) PART[(size_t)(u.pn * 4 + wc) * M + row] = ss; }
    }
};
struct EpiUp {
    static constexpr bool PERM = true;
    bf16_t* HID; const PG8_LAS float* rs;
    __device__ __forceinline__ void operator()(const f32x4 (&acc)[2][2][4][2], const Unit& u, int wr, int wc, int fr, int fq) const {
        const int rl0 = wr * 64 + fr, col0 = u.pn * BM + wc * 32 + 8 * fq; const PG8_LAS float* rt = rs + u.idx * 256;
#pragma unroll
        for (int ai = 0; ai < 2; ++ai)
#pragma unroll
            for (int m = 0; m < 4; ++m) { const int rl = rl0 + ai * HALF + m * 16; const float r = rt[rl]; bf16_t* rowp = HID + (size_t)(u.pm * BM + rl) * 4096 + col0;
#pragma unroll
                for (int bj = 0; bj < 2; ++bj) { f32x4 v0 = acc[ai][bj][m][0] * r, v1 = acc[ai][bj][m][1] * r;
#pragma unroll
                    for (int e = 0; e < 4; ++e) { const float a = __builtin_fmaxf(v0[e], 0.f), b = __builtin_fmaxf(v1[e], 0.f); v0[e] = a * a; v1[e] = b * b; }
                    u32x4 w; w.x = cvt_pk_bf16(v0[0], v0[1]); w.y = cvt_pk_bf16(v0[2], v0[3]); w.z = cvt_pk_bf16(v1[0], v1[1]); w.w = cvt_pk_bf16(v1[2], v1[3]);
                    *(u32x4*)(rowp + bj * HALF) = w; } }
    }
};
struct EpiDown {
    static constexpr bool PERM = true;
    const float* H1; float* OUT;
    __device__ __forceinline__ void operator()(const f32x4 (&acc)[2][2][4][2], const Unit& u, int wr, int wc, int fr, int fq) const {
        const int row0 = u.pm * BM + wr * 64 + fr, col0 = u.pn * BM + wc * 32 + 8 * fq;
#pragma unroll
        for (int ai = 0; ai < 2; ++ai)
#pragma unroll
            for (int m = 0; m < 4; ++m) { const size_t off = (size_t)(row0 + ai * HALF + m * 16) * 1024 + col0;
#pragma unroll
                for (int bj = 0; bj < 2; ++bj) {
                    const f32x4 h0 = acc[ai][bj][m][0] + *(const f32x4*)(H1 + off + bj * HALF), h1 = acc[ai][bj][m][1] + *(const f32x4*)(H1 + off + bj * HALF + 4);
                    *(f32x4*)(OUT + off + bj * HALF) = h0; *(f32x4*)(OUT + off + bj * HALF + 4) = h1; } }
    }
};

template <class Epi, class Sched, bool ALIGN_EPI = false, bool SP2 = false>
__device__ __forceinline__ void gemm_phase(PG8_LAS unsigned char* lds, const Gemm g, const Sched& S, const Epi& E) {
    const int tid = threadIdx.x, wid = __builtin_amdgcn_readfirstlane(tid >> 6), lane = tid & 63, wr = wid >> 2, wc = wid & 3, fr = lane & 15, fq = lane >> 4;
    const int K = g.K, nt = K / BK;
    unsigned voffA[2], voffB[2];
#pragma unroll
    for (int i = 0; i < 2; ++i) { int R, C; stage_rc(tid * 16 + i * 8192, R, C); const int Rb = Epi::PERM ? ((R & ~31) + perm32(R & 31)) : R;
        voffA[i] = (unsigned)(R * g.lda + C) * 2u; voffB[i] = (unsigned)(Rb * g.ldb + C) * 2u; }
    const size_t kstep = (size_t)(BK * 2);
    const size_t hstepA = (size_t)HALF * g.lda * 2, hstepB = (size_t)HALF * g.ldb * 2;
    const unsigned ldsw = (unsigned)wid * 1024u;
    const int aoff = lds_byte(wr * 64 + fr, fq * 8), boff = lds_byte(wc * 32 + fr, fq * 8);
#define PG8_APTR(u) ((const char*)((u).z ? g.A1 : g.A0) + ((size_t)(u).pm * BM * g.lda + (size_t)(u).pn * g.a_pn_step) * 2)
#define PG8_BPTR(u) ((const char*)((u).z ? g.B1 : g.B0) + ((size_t)(u).pn * BM * g.ldb) * 2)
#define PG8_SA(b, h) (((b) * 2 + (h)) * HTB)
#define PG8_SB(b, h) ((4 + (b) * 2 + (h)) * HTB)
#define PG8_STAGE(bufoff, gbase, voff) do { _Pragma("unroll") for (int _i = 0; _i < 2; ++_i) \
        __builtin_amdgcn_global_load_lds((const unsigned*)((const char*)(gbase) + (voff)[_i]), (PG8_LAS unsigned*)(lds + (bufoff) + ldsw + _i * 8192), 16, 0, 0); } while (0)
#define PG8_LDA(dst, b, h) do { _Pragma("unroll") for (int m = 0; m < 4; ++m) _Pragma("unroll") for (int k = 0; k < 2; ++k) dst[m][k] = *(const PG8_LAS bf16x8*)(lds + PG8_SA(b, h) + aoff + m * 2048 + k * 1024); } while (0)
#define PG8_LDB(dst, b, h) do { _Pragma("unroll") for (int n = 0; n < 2; ++n) _Pragma("unroll") for (int k = 0; k < 2; ++k) dst[n][k] = *(const PG8_LAS bf16x8*)(lds + PG8_SB(b, h) + boff + n * 2048 + k * 1024); } while (0)
#define PG8_MMA(ai, bj, At, Bt) do { __builtin_amdgcn_s_setprio(1); _Pragma("unroll") for (int m = 0; m < 4; ++m) _Pragma("unroll") for (int n = 0; n < 2; ++n) _Pragma("unroll") for (int k = 0; k < 2; ++k) \
        acc[ai][bj][m][n] = __builtin_amdgcn_mfma_f32_16x16x32_bf16(Bt[n][k], At[m][k], acc[ai][bj][m][n], 0, 0, 0); __builtin_amdgcn_s_setprio(0); } while (0)
#define PG8_WAIT_V(n) asm volatile("s_waitcnt vmcnt(" #n ")" ::: "memory")
#define PG8_WAIT_L(n) asm volatile("s_waitcnt lgkmcnt(" #n ")" ::: "memory")
#define PG8_BAR __builtin_amdgcn_s_barrier()
#define PG8_SCHED __builtin_amdgcn_sched_barrier(0)
    Unit cur, nxt; int ui = 0;
    if (!S.next(0, cur)) return;
    f32x4 acc[2][2][4][2];
#pragma unroll
    for (int a = 0; a < 2; ++a)
#pragma unroll
        for (int b = 0; b < 2; ++b)
#pragma unroll
            for (int m = 0; m < 4; ++m)
#pragma unroll
                for (int n = 0; n < 2; ++n) acc[a][b][m][n] = (f32x4){0.f, 0.f, 0.f, 0.f};
    bf16x8 At[4][2], B0[2][2], B1[2][2];
    const char* cA = PG8_APTR(cur); const char* cB = PG8_BPTR(cur);
    if constexpr (SP2) {
        PG8_STAGE(PG8_SB(0, 0), cB, voffB); PG8_STAGE(PG8_SB(0, 1), cB + hstepB, voffB); PG8_STAGE(PG8_SA(0, 0), cA, voffA); PG8_STAGE(PG8_SA(0, 1), cA + hstepA, voffA);
        if (wr == 1) PG8_BAR;
        PG8_WAIT_V(2); PG8_BAR;
        PG8_STAGE(PG8_SB(1, 0), cB + kstep, voffB); PG8_STAGE(PG8_SA(1, 0), cA + kstep, voffA); PG8_STAGE(PG8_SB(1, 1), cB + hstepB + kstep, voffB);
        PG8_WAIT_V(6); PG8_BAR;
    } else {
        PG8_STAGE(PG8_SB(0, 0), cB, voffB); PG8_STAGE(PG8_SA(0, 0), cA, voffA); PG8_STAGE(PG8_SB(0, 1), cB + hstepB, voffB); PG8_STAGE(PG8_SA(0, 1), cA + hstepA, voffA);
        if (wr == 1) PG8_BAR;
        PG8_WAIT_V(4); PG8_BAR;
        PG8_STAGE(PG8_SB(1, 0), cB + kstep, voffB); PG8_STAGE(PG8_SA(1, 0), cA + kstep, voffA); PG8_STAGE(PG8_SB(1, 1), cB + hstepB + kstep, voffB);
        PG8_WAIT_V(6); PG8_BAR;
    }
    for (;;) {
        const bool has_next = S.next(ui + 1, nxt);
        const char* nA = has_next ? PG8_APTR(nxt) : cA; const char* nB = has_next ? PG8_BPTR(nxt) : cB;
        for (int t = 0; t < nt; t += 2) {
            const bool last = (t == nt - 2);
            const char* a1 = cA + (size_t)(t + 1) * kstep;
            const char* a2 = last ? nA : cA + (size_t)(t + 2) * kstep; const char* b2 = last ? nB : cB + (size_t)(t + 2) * kstep;
            const char* a3 = a2 + kstep; const char* b3 = b2 + kstep;
            if constexpr (SP2) {
            PG8_LDB(B0, 0, 0); PG8_LDB(B1, 0, 1); PG8_SCHED; PG8_LDA(At, 0, 0); PG8_STAGE(PG8_SA(1, 1), a1 + hstepA, voffA);
            PG8_WAIT_V(8); PG8_WAIT_L(0); PG8_BAR; PG8_MMA(0, 0, At, B0); PG8_MMA(0, 1, At, B1); PG8_BAR; PG8_SCHED;
            PG8_LDA(At, 0, 1); PG8_STAGE(PG8_SB(0, 0), b2, voffB); PG8_STAGE(PG8_SB(0, 1), b2 + hstepB, voffB); PG8_STAGE(PG8_SA(0, 0), a2, voffA);
            PG8_WAIT_V(8); PG8_WAIT_L(0); PG8_BAR; PG8_MMA(1, 0, At, B0); PG8_MMA(1, 1, At, B1); PG8_BAR; PG8_SCHED;
            PG8_LDB(B0, 1, 0); PG8_LDB(B1, 1, 1); PG8_SCHED; PG8_LDA(At, 1, 0); PG8_STAGE(PG8_SA(0, 1), a2 + hstepA, voffA);
            PG8_WAIT_V(8); PG8_WAIT_L(0); PG8_BAR; PG8_MMA(0, 0, At, B0); PG8_MMA(0, 1, At, B1); PG8_BAR; PG8_SCHED;
            PG8_LDA(At, 1, 1); PG8_STAGE(PG8_SB(1, 0), b3, voffB); PG8_STAGE(PG8_SB(1, 1), b3 + hstepB, voffB); PG8_STAGE(PG8_SA(1, 0), a3, voffA);
            PG8_WAIT_V(8); PG8_WAIT_L(0); PG8_BAR; PG8_MMA(1, 0, At, B0); PG8_MMA(1, 1, At, B1); PG8_BAR; PG8_SCHED;
            } else {
            PG8_LDB(B0, 0, 0); PG8_SCHED; PG8_LDA(At, 0, 0); PG8_STAGE(PG8_SA(1, 1), a1 + hstepA, voffA);
            PG8_WAIT_L(8); PG8_BAR; PG8_WAIT_L(0); PG8_MMA(0, 0, At, B0); PG8_BAR; PG8_SCHED;
            PG8_LDB(B1, 0, 1); PG8_STAGE(PG8_SB(0, 0), b2, voffB);
            PG8_BAR; PG8_WAIT_L(0); PG8_MMA(0, 1, At, B1); PG8_BAR;
            PG8_LDA(At, 0, 1); PG8_STAGE(PG8_SA(0, 0), a2, voffA);
            PG8_BAR; PG8_WAIT_L(0); PG8_MMA(1, 0, At, B0); PG8_BAR; PG8_SCHED;
            PG8_STAGE(PG8_SB(0, 1), b2 + hstepB, voffB);
            PG8_WAIT_V(6); PG8_BAR; PG8_MMA(1, 1, At, B1); PG8_BAR;
            PG8_LDB(B0, 1, 0); PG8_SCHED; PG8_LDA(At, 1, 0); PG8_STAGE(PG8_SA(0, 1), a2 + hstepA, voffA);
            PG8_WAIT_L(8); PG8_BAR; PG8_WAIT_L(0); PG8_MMA(0, 0, At, B0); PG8_BAR; PG8_SCHED;
            PG8_LDB(B1, 1, 1); PG8_STAGE(PG8_SB(1, 0), b3, voffB);
            PG8_BAR; PG8_WAIT_L(0); PG8_MMA(0, 1, At, B1); PG8_BAR;
            PG8_LDA(At, 1, 1); PG8_STAGE(PG8_SA(1, 0), a3, voffA);
            PG8_BAR; PG8_WAIT_L(0); PG8_MMA(1, 0, At, B0); PG8_BAR; PG8_SCHED;
            PG8_STAGE(PG8_SB(1, 1), b3 + hstepB, voffB);
            PG8_WAIT_V(6); PG8_BAR; PG8_MMA(1, 1, At, B1); PG8_BAR;
            }
        }
        if constexpr (ALIGN_EPI) { if (wr == 0) PG8_BAR; }
        E(acc, cur, wr, wc, fr, fq);
        if (!has_next) break;
#pragma unroll
        for (int a = 0; a < 2; ++a)
#pragma unroll
            for (int b = 0; b < 2; ++b)
#pragma unroll
                for (int m = 0; m < 4; ++m)
#pragma unroll
                    for (int n = 0; n < 2; ++n) acc[a][b][m][n] = (f32x4){0.f, 0.f, 0.f, 0.f};
        cur = nxt; cA = nA; cB = nB; ++ui;
        if constexpr (ALIGN_EPI) { if (wr == 1) PG8_BAR; }
    }
    PG8_WAIT_V(0);
    if constexpr (!ALIGN_EPI) { if (wr == 0) PG8_BAR; }
    PG8_BAR;
#undef PG8_APTR
#undef PG8_BPTR
#undef PG8_SA
#undef PG8_SB
#undef PG8_STAGE
#undef PG8_LDA
#undef PG8_LDB
#undef PG8_MMA
#undef PG8_WAIT_V
#undef PG8_WAIT_L
#undef PG8_BAR
#undef PG8_SCHED
}
}

constexpr int NWAVES = 8;
constexpr int BATCH = 4, SEQ = 8192, D = 1024, NMETA = 16, FF = 4096;
constexpr int M = BATCH * SEQ;
constexpr int NQH = 16, NKVH = 4, HD = 64, KVW = NKVH * HD;
constexpr int NIN = 4608;
constexpr float RMS_EPS = 1e-5f;
constexpr float LOG2E = 1.4426950408889634f;
constexpr float QSCALE = 0.125f * LOG2E;
constexpr int N_PHASES = 9;
constexpr int N_LAUNCHES = MK_N_LAUNCHES;

constexpr size_t MiB = 1u << 20;
constexpr size_t WS_CTL = 0, CTL_ZERO_BYTES = 64 * 1024;
constexpr size_t WS_PART = 1 * MiB;
constexpr size_t WS_META = 3 * MiB;
constexpr size_t WS_WIN = 4 * MiB, WS_PW = 13 * MiB, WS_WPB = 14 * MiB, WS_WAB = 16 * MiB, WS_WOUT = 18 * MiB, WS_WUP = 20 * MiB, WS_WDN = 28 * MiB;
constexpr size_t WS_H1 = 40 * MiB;
constexpr size_t WS_GP = 40 * MiB, WS_GA = 104 * MiB;
constexpr size_t WS_U2 = 168 * MiB;
constexpr size_t WS_K = 168 * MiB, WS_V = 184 * MiB;
constexpr size_t WS_HID = 232 * MiB;
constexpr size_t WS_A0 = 232 * MiB;
constexpr size_t WS_A1 = 296 * MiB;
constexpr size_t WS_A2 = 360 * MiB;
constexpr size_t WS_A3 = 424 * MiB;
constexpr size_t WS_END = 488 * MiB;
static_assert(WS_WIN + (size_t)NIN * D * 2 <= WS_PW && WS_WDN + (size_t)D * FF * 2 <= WS_H1 && WS_HID + (size_t)M * FF * 2 == WS_END, "d_ws map");
constexpr int CW_BAR = 1024;

constexpr int RING_OFF = 0, RING_BYTES = 131072;
constexpr int LDSCTL_OFF = RING_BYTES, MISC_OFF = LDSCTL_OFF + 320;
constexpr int TAB_OFF = RING_BYTES + 512;
constexpr int LDS_BYTES = 147456;

#define GAS __attribute__((address_space(1)))
#define LAS __attribute__((address_space(3)))
typedef unsigned short bf16;
typedef unsigned v4u __attribute__((ext_vector_type(4)));
typedef unsigned v2u __attribute__((ext_vector_type(2)));
typedef float f32x4 __attribute__((ext_vector_type(4)));
typedef GAS unsigned gu32;
#define RLX_AGENT __ATOMIC_RELAXED, __HIP_MEMORY_SCOPE_AGENT
#define LDS_WAIT() asm volatile("s_waitcnt lgkmcnt(0)" ::: "memory")
#define VM_WAIT() asm volatile("s_waitcnt vmcnt(0)" ::: "memory")
__device__ __forceinline__ unsigned f2bf(float f) { unsigned u = __builtin_bit_cast(unsigned, f); return (u + 0x7fffu + ((u >> 16) & 1u)) >> 16; }
__device__ __forceinline__ unsigned pk2(float lo, float hi) { return f2bf(lo) | (f2bf(hi) << 16); }
__device__ __forceinline__ float bflo(unsigned w) { return __builtin_bit_cast(float, w << 16); }
__device__ __forceinline__ float bfhi(unsigned w) { return __builtin_bit_cast(float, w & 0xffff0000u); }

#define XB_TMO      128
#define XB_XCNT(j)  (256  + 64 * (j))
#define XB_XSUB(j)  (1280 + 64 * (j))
#define XB_XGEN(j)  (2304 + 64 * (j))
#define XB_TOP      3328
#define XB_TOPGEN   3392
#define XCD_BAR_WORDS 3456
#define XB_SPIN_CAP (1u << 18)
__device__ __forceinline__ unsigned xb_ld(unsigned* p)              { return __hip_atomic_load(p, __ATOMIC_RELAXED, __HIP_MEMORY_SCOPE_AGENT); }
__device__ __forceinline__ unsigned xb_add(unsigned* p, unsigned v) { return __hip_atomic_fetch_add(p, v, __ATOMIC_RELAXED, __HIP_MEMORY_SCOPE_AGENT); }
__device__ __forceinline__ unsigned xb_xcc_id() { return (unsigned)__builtin_amdgcn_s_getreg((3 << 11) | 20) & 0xFu; }
#define XB_SPIN(cond, bar) do { unsigned _sp = 0; while (cond) { __builtin_amdgcn_s_sleep(1); \
    if ((++_sp & 255u) == 0u) { if (xb_ld(&(bar)[XB_TMO])) break; if (_sp > XB_SPIN_CAP) { atomicAdd(&(bar)[XB_TMO], 1u); break; } } } } while (0)
struct XcdBarrier { unsigned* bar; unsigned x; volatile LAS unsigned* st; };
__device__ __forceinline__ XcdBarrier xcd_barrier_post(unsigned* bar, volatile LAS unsigned* st) {
    XcdBarrier b; b.bar = bar; b.x = xb_xcc_id(); b.st = st;
    if (threadIdx.x == 0) (void)xb_add(&bar[XB_XCNT(b.x)], 1u);
    return b;
}
__device__ __forceinline__ void xcd_barrier_complete(unsigned* bar, unsigned x, unsigned& nloc, unsigned& nx) {
    const unsigned G = gridDim.x * gridDim.y * gridDim.z;
    unsigned sum, cnt, mine, sp = 0u;
    for (;;) {
        sum = 0u; cnt = 0u; mine = 0u;
#pragma unroll
        for (unsigned j = 0; j < 16; ++j) { const unsigned c = xb_ld(&bar[XB_XCNT(j)]); sum += c; cnt += (c > 0u) ? 1u : 0u; mine = (j == x) ? c : mine; }
        if (sum == G) break;
        __builtin_amdgcn_s_sleep(1);
        if ((++sp & 255u) == 0u) { if (xb_ld(&bar[XB_TMO])) break; if (sp > XB_SPIN_CAP) { atomicAdd(&bar[XB_TMO], 1u); break; } }
    }
    nloc = mine > 0u ? mine : 1u; nx = cnt > 0u ? cnt : 1u;
}
__device__ __forceinline__ void xcd_barrier(const XcdBarrier& b) {
    asm volatile("s_waitcnt vmcnt(0)" ::: "memory");
    __syncthreads();
    if (threadIdx.x == 0) {
        unsigned* bar = b.bar;
        __builtin_amdgcn_s_waitcnt(0);
        unsigned nloc = b.st[0], nx = b.st[1];
        if (nloc == 0u) { xcd_barrier_complete(bar, b.x, nloc, nx); b.st[0] = nloc; b.st[1] = nx; }
        const unsigned old = xb_add(&bar[XB_XSUB(b.x)], 1u);
        const unsigned gen = old / nloc;
        if (old + 1u == (gen + 1u) * nloc) {
            __builtin_amdgcn_fence(__ATOMIC_RELEASE, "agent");
            asm volatile("s_waitcnt vmcnt(0)" ::: "memory");
            const unsigned og = xb_add(&bar[XB_TOP], 1u);
            const unsigned tg = og / nx;
            if (og + 1u == (tg + 1u) * nx) xb_add(&bar[XB_TOPGEN], 1u);
            else XB_SPIN(xb_ld(&bar[XB_TOPGEN]) == tg, bar);
            __builtin_amdgcn_fence(__ATOMIC_ACQUIRE, "agent");
            xb_add(&bar[XB_XGEN(b.x)], 1u);
            asm volatile("s_waitcnt vmcnt(0)" ::: "memory");
        } else {
            XB_SPIN(xb_ld(&bar[XB_XGEN(b.x)]) == gen, bar);
            __builtin_amdgcn_fence(__ATOMIC_ACQUIRE, "agent");
            asm volatile("s_waitcnt vmcnt(0)" ::: "memory");
        }
    }
    __syncthreads();
}

__device__ __forceinline__ float wave_sum(float v) {
#pragma unroll
    for (int o = 1; o < 64; o <<= 1) v += __shfl_xor(v, o);
    return v;
}
__device__ __forceinline__ void p0_transpose_item(const float* W, int K, int N, bf16* WT, int row_off, LAS float* scr, int item, int lane) {
    const int nblk = N / 32, kb = item / nblk, nb = item % nblk, k0 = 64 * kb, n0 = 32 * nb;
#pragma unroll 8
    for (int i = 0; i < 32; ++i) { const int kk = 2 * i + (lane >> 5); scr[kk * 33 + (lane & 31)] = W[(size_t)(k0 + kk) * N + n0 + (lane & 31)]; }
    LDS_WAIT(); asm volatile("" ::: "memory");
    const int c = lane & 7;
#pragma unroll
    for (int j = 0; j < 4; ++j) { const int n = (lane >> 3) + 8 * j; const LAS float* s = scr + (8 * c) * 33 + n;
        v4u o; o.x = pk2(s[0 * 33], s[1 * 33]); o.y = pk2(s[2 * 33], s[3 * 33]); o.z = pk2(s[4 * 33], s[5 * 33]); o.w = pk2(s[6 * 33], s[7 * 33]);
        *(GAS v4u*)(WT + (size_t)(row_off + n0 + n) * K + k0 + 8 * c) = o; }
    LDS_WAIT(); asm volatile("" ::: "memory");
}
__device__ __forceinline__ void rms_row_to_bf16(int lane, const float* xrow, const float* g, bf16* orow) {
    const GAS f32x4* xr = (const GAS f32x4*)xrow + lane; const GAS f32x4* gr = (const GAS f32x4*)g + lane;
    f32x4 v[4]; float s = 0.f;
#pragma unroll
    for (int j = 0; j < 4; ++j) { v[j] = xr[64 * j]; s += (v[j].x * v[j].x + v[j].y * v[j].y) + (v[j].z * v[j].z + v[j].w * v[j].w); }
    const float rstd = 1.f / sqrtf(wave_sum(s) * (1.f / D) + RMS_EPS);
    GAS unsigned long long* o8 = (GAS unsigned long long*)orow + lane;
#pragma unroll
    for (int j = 0; j < 4; ++j) { const f32x4 gv = gr[64 * j];
        o8[64 * j] = (unsigned long long)pk2(v[j].x * rstd * gv.x, v[j].y * rstd * gv.y) | ((unsigned long long)pk2(v[j].z * rstd * gv.z, v[j].w * rstd * gv.w) << 32); }
}
__device__ __forceinline__ int t5_bucket(int d) {
    if (d < 16) return d;
    int b = 16;
    b += (d >= 19); b += (d >= 21); b += (d >= 24); b += (d >= 27); b += (d >= 31); b += (d >= 35); b += (d >= 40); b += (d >= 46);
    b += (d >= 52); b += (d >= 59); b += (d >= 67); b += (d >= 77); b += (d >= 87); b += (d >= 99); b += (d >= 113);
    return b;
}

namespace att {
typedef short bf16x8 __attribute__((ext_vector_type(8)));
typedef short s16x4 __attribute__((ext_vector_type(4)));
typedef short v4i16_t __attribute__((ext_vector_type(4)));
typedef float f32x16 __attribute__((ext_vector_type(16)));
typedef float f32x2_t __attribute__((ext_vector_type(2))); typedef __bf16 bf16x2_t __attribute__((ext_vector_type(2)));
constexpr int KRS = 144, VRS = 192, NROWS = 272;
constexpr int LK = 0, LV = NROWS * KRS, LST = LV + NROWS * VRS, STW = 32 * 144, LEND = LST + NWAVES * STW;
static_assert(LEND <= RING_BYTES, "attention LDS map");
__device__ __forceinline__ int crow(int r, int hi) { return (r & 3) + 8 * (r >> 2) + 4 * hi; }
__device__ __forceinline__ unsigned cvtpk(float lo, float hi) { f32x2_t v = {lo, hi}; bf16x2_t b = __builtin_convertvector(v, bf16x2_t); return __builtin_bit_cast(unsigned, b); }
__device__ __forceinline__ s16x4 vtr(const LAS unsigned char* p) { return __builtin_bit_cast(s16x4, __builtin_amdgcn_ds_read_tr16_b64_v4i16((LAS v4i16_t*)p)); }

__device__ __forceinline__ void build_tab(LAS float* tab, const float* rel_bias, int tid) {
    for (int i = tid; i < NQH * 192; i += NWAVES * 64) { const int hq = i / 192, t = i % 192, dist = 159 - t;
        tab[i] = (dist >= 0 && dist < 128) ? rel_bias[t5_bucket(dist) * NQH + hq] * LOG2E : -INFINITY; }
}

__device__ __forceinline__ void attn_unit(LAS unsigned char* lds, const LAS float* tab, int b, int hkv, int n, const bf16* Q, const bf16* Kb, const bf16* Vb, const bf16* Km, const bf16* Vm,
                                          bf16* O, const float* rel_bias, const float* sinks) {
    const int tid = threadIdx.x, lane = tid & 63, wid = __builtin_amdgcn_readfirstlane(tid >> 6), r32 = lane & 31, hi = lane >> 5;
    const int s0 = n * 128; const size_t rowb = (size_t)b * SEQ;
    {
        v4u kv[4], vv[4], km = {0u, 0u, 0u, 0u}, vm = {0u, 0u, 0u, 0u};
#pragma unroll
        for (int i = 0; i < 4; ++i) { const int idx = tid + i * 512, row = idx >> 3, ch = idx & 7, sp = s0 - 128 + row;
            if (sp >= 0) { const size_t off = (rowb + sp) * KVW + hkv * HD + ch * 8; kv[i] = *(const GAS v4u*)(Kb + off); vv[i] = *(const GAS v4u*)(Vb + off); }
            else { kv[i] = (v4u){0u, 0u, 0u, 0u}; vv[i] = (v4u){0u, 0u, 0u, 0u}; } }
        if (tid < 128) { const int row = tid >> 3, ch = tid & 7; const size_t off = (size_t)row * KVW + hkv * HD + ch * 8; km = *(const GAS v4u*)(Km + off); vm = *(const GAS v4u*)(Vm + off); }
#pragma unroll
        for (int i = 0; i < 4; ++i) { const int idx = tid + i * 512, row = idx >> 3, ch = idx & 7;
            *(LAS v4u*)(lds + LK + (16 + row) * KRS + ch * 16) = kv[i]; *(LAS v4u*)(lds + LV + (16 + row) * VRS + ch * 16) = vv[i]; }
        if (tid < 128) { const int row = tid >> 3, ch = tid & 7; *(LAS v4u*)(lds + LK + row * KRS + ch * 16) = km; *(LAS v4u*)(lds + LV + row * VRS + ch * 16) = vm; }
    }
    __syncthreads();
    const int g = wid >> 1, hq = hkv * 4 + g;
    const float sink2 = sinks[hq] * LOG2E, bm31 = rel_bias[31 * NQH + hq] * LOG2E;
    LAS unsigned char* st = lds + LST + wid * STW;
    const LAS float* tb = tab + hq * 192 + (31 - r32 + 4 * hi);
    const int G4 = lane >> 4, i16 = lane & 15, qq = i16 >> 2, p4 = i16 & 3;
    const LAS unsigned char* vb = lds + LV + (4 * hi + qq) * VRS + (16 * (G4 & 1) + 4 * p4) * 2;
#pragma unroll 1
    for (int e = 0; e < 2; ++e) {
        const int qs = (wid & 1) * 2 + e, qo = qs * 32;
        const bf16* qp = Q + (rowb + s0 + qo + r32) * D + hq * HD + hi * 8;
        bf16x8 qr[4];
#pragma unroll
        for (int s2 = 0; s2 < 4; ++s2) qr[s2] = *(const GAS bf16x8*)(qp + s2 * 16);
        f32x16 sc[6];
#pragma unroll
        for (int t = 0; t < 6; ++t) { const int rowbase = (t == 0) ? 0 : 16 + 32 * (qs + t - 1);
            const LAS unsigned char* kp = lds + LK + (rowbase + r32) * KRS + hi * 16;
            f32x16 a = {0.f, 0.f, 0.f, 0.f, 0.f, 0.f, 0.f, 0.f, 0.f, 0.f, 0.f, 0.f, 0.f, 0.f, 0.f, 0.f};
#pragma unroll
            for (int s2 = 0; s2 < 4; ++s2) { const bf16x8 kf = *(const LAS bf16x8*)(kp + s2 * 32); a = __builtin_amdgcn_mfma_f32_32x32x16_bf16(kf, qr[s2], a, 0, 0, 0); }
            sc[t] = a; }
#pragma unroll
        for (int t = 1; t < 6; ++t) {
#pragma unroll
            for (int r = 0; r < 16; ++r) sc[t][r] += tb[32 * (t - 1) + (r & 3) + 8 * (r >> 2)];
            if (n == 0 && qs + t - 1 < 4) {
#pragma unroll
                for (int r = 0; r < 16; ++r) sc[t][r] = -INFINITY; } }
        if (n != 0) {
#pragma unroll
            for (int r = 0; r < 8; ++r) sc[0][r] += bm31;
        } else {
#pragma unroll
            for (int r = 0; r < 8; ++r) { int d = qo + r32 + 16 - crow(r, hi); d = d > 128 ? 128 : d; sc[0][r] += rel_bias[t5_bucket(d) * NQH + hq] * LOG2E; }
        }
#pragma unroll
        for (int r = 8; r < 16; ++r) sc[0][r] = -INFINITY;
        float mx = sink2;
#pragma unroll
        for (int t = 0; t < 6; ++t)
#pragma unroll
            for (int r = 0; r < 16; ++r) mx = __builtin_fmaxf(mx, sc[t][r]);
        mx = __builtin_fmaxf(mx, __shfl_xor(mx, 32));
        float l = 0.f;
#pragma unroll
        for (int t = 0; t < 6; ++t)
#pragma unroll
            for (int r = 0; r < 16; ++r) { const float p = __builtin_amdgcn_exp2f(sc[t][r] - mx); sc[t][r] = p; l += p; }
        l += __shfl_xor(l, 32);
        l += __builtin_amdgcn_exp2f(sink2 - mx);
        const float inv = 1.0f / l;
        f32x16 o0 = {0.f, 0.f, 0.f, 0.f, 0.f, 0.f, 0.f, 0.f, 0.f, 0.f, 0.f, 0.f, 0.f, 0.f, 0.f, 0.f}, o1 = o0;
#pragma unroll
        for (int t = 0; t < 6; ++t) { const int rowbase = (t == 0) ? 0 : 16 + 32 * (qs + t - 1);
#pragma unroll
            for (int s = 0; s < 2; ++s) {
                v4u pw; pw.x = cvtpk(sc[t][8 * s + 0], sc[t][8 * s + 1]); pw.y = cvtpk(sc[t][8 * s + 2], sc[t][8 * s + 3]); pw.z = cvtpk(sc[t][8 * s + 4], sc[t][8 * s + 5]); pw.w = cvtpk(sc[t][8 * s + 6], sc[t][8 * s + 7]);
                const bf16x8 pf = __builtin_bit_cast(bf16x8, pw);
                const LAS unsigned char* vp = vb + (rowbase + 16 * s) * VRS;
                const s16x4 lo0 = vtr(vp), hi0 = vtr(vp + 8 * VRS), lo1 = vtr(vp + 64), hi1 = vtr(vp + 8 * VRS + 64);
                const bf16x8 a0 = {lo0[0], lo0[1], lo0[2], lo0[3], hi0[0], hi0[1], hi0[2], hi0[3]}, a1 = {lo1[0], lo1[1], lo1[2], lo1[3], hi1[0], hi1[1], hi1[2], hi1[3]};
                o0 = __builtin_amdgcn_mfma_f32_32x32x16_bf16(a0, pf, o0, 0, 0, 0);
                o1 = __builtin_amdgcn_mfma_f32_32x32x16_bf16(a1, pf, o1, 0, 0, 0); } }
#pragma unroll
        for (int rr = 0; rr < 4; ++rr) {
            v2u w0; w0.x = cvtpk(o0[4 * rr] * inv, o0[4 * rr + 1] * inv); w0.y = cvtpk(o0[4 * rr + 2] * inv, o0[4 * rr + 3] * inv);
            v2u w1; w1.x = cvtpk(o1[4 * rr] * inv, o1[4 * rr + 1] * inv); w1.y = cvtpk(o1[4 * rr + 2] * inv, o1[4 * rr + 3] * inv);
            *(LAS v2u*)(st + r32 * 144 + (8 * rr + 4 * hi) * 2) = w0;
            *(LAS v2u*)(st + r32 * 144 + (32 + 8 * rr + 4 * hi) * 2) = w1; }
        LDS_WAIT();
        bf16* op = O + (rowb + s0 + qo) * D + hq * HD;
#pragma unroll
        for (int i = 0; i < 4; ++i) { const int row = i * 8 + (lane >> 3), ch = lane & 7; const v4u v = *(const LAS v4u*)(st + row * 144 + ch * 16); *(GAS v4u*)(op + (size_t)row * D + ch * 8) = v; }
        LDS_WAIT();
    }
    __syncthreads();
}
}

struct Args { const float* in[15]; float* out; unsigned char* ws; int ph_lo, ph_hi, li, pad; };
__global__ void __launch_bounds__(NWAVES * 64, 2) fwd_megakernel(Args args) {
    extern __shared__ __attribute__((aligned(16))) unsigned char lds_raw[];
    LAS unsigned char* lds = (LAS unsigned char*)lds_raw;
    volatile LAS unsigned* MISC = (volatile LAS unsigned*)(lds + MISC_OFF);
    const int tid = threadIdx.x, lane = tid & 63, wave = __builtin_amdgcn_readfirstlane(tid >> 6);
    const int G = gridDim.x; const int bx = blockIdx.x; const int vcu = (G % 8 == 0) ? (bx % 8) * (G / 8) + bx / 8 : bx;
    unsigned char* ws = args.ws;
    gu32* ctl = (gu32*)(ws + WS_CTL);
    const float* x = args.in[0]; const float* meta = args.in[1]; const float* rel_bias = args.in[2]; const float* g_mix = args.in[3]; const float* w_in = args.in[4];
    const float* pool_w = args.in[5]; const float* pool_scale = args.in[6]; const float* w_pool_br = args.in[7]; const float* sinks = args.in[8]; const float* w_attn_br = args.in[9];
    const float* w_out = args.in[10]; const float* g_mlp = args.in[11]; const float* w_up = args.in[12]; const float* w_down = args.in[13]; const float* g_final = args.in[14];
    float* out = args.out;
#define WSP(T, off) ((T*)(wsl + (off)))
#define PHASE_WS() unsigned char* wsl = ws; asm volatile("" : "+s"(wsl))
#define Win_t  WSP(bf16, WS_WIN)
#define PW_t   WSP(bf16, WS_PW)
#define Wpb_t  WSP(bf16, WS_WPB)
#define Wab_t  WSP(bf16, WS_WAB)
#define Wout_t WSP(bf16, WS_WOUT)
#define Wup_t  WSP(bf16, WS_WUP)
#define Wdn_t  WSP(bf16, WS_WDN)
#define ZPm    WSP(bf16, WS_META)
#define Km     WSP(bf16, WS_META + 16 * 1024 * 2)
#define Vm     WSP(bf16, WS_META + 16 * 1024 * 2 + 16 * 256 * 2)
#define PART   WSP(float, WS_PART)
#define XN     WSP(bf16, WS_A0)
#define POOLED WSP(bf16, WS_A0)
#define MERGED WSP(bf16, WS_A0)
#define ZP     WSP(bf16, WS_A1)
#define MIXED  WSP(bf16, WS_A1)
#define Qb     WSP(bf16, WS_A2)
#define T1     WSP(bf16, WS_A2)
#define Ob     WSP(bf16, WS_A3)
#define GP     WSP(bf16, WS_GP)
#define GA     WSP(bf16, WS_GA)
#define Kb     WSP(bf16, WS_K)
#define Vb     WSP(bf16, WS_V)
#define H1     WSP(float, WS_H1)
#define U2     WSP(bf16, WS_U2)
#define HID    WSP(bf16, WS_HID)

    for (int u = tid; u < (LDS_BYTES - LDSCTL_OFF) / 4; u += NWAVES * 64) ((LAS unsigned*)(lds + LDSCTL_OFF))[u] = 0u;
    __syncthreads();
    XcdBarrier bar; bar.bar = (unsigned*)(ctl + CW_BAR); bar.x = 0; bar.st = nullptr;
    if (N_LAUNCHES == 1) bar = xcd_barrier_post((unsigned*)(ctl + CW_BAR), MISC + 8);
#define GRID_BAR() do { if (N_LAUNCHES == 1) xcd_barrier(bar); } while (0)
    const int lo = args.ph_lo, hi = args.ph_hi;
#define IN(k) (lo <= (k) && (k) < hi)
#define BOTH(k) (IN(k) && IN((k) + 1))

    if (IN(0)) { PHASE_WS();
        if (vcu < 24) {
            LAS float* um = (LAS float*)(lds + RING_OFF);
            LAS float* red = (LAS float*)(lds + RING_OFF + 65536);
#pragma unroll 1
            for (int rr = 0; rr < 2; ++rr) { const int r = 2 * wave + rr;
                const GAS f32x4* xr = (const GAS f32x4*)(meta + (size_t)r * D) + lane; const GAS f32x4* gr = (const GAS f32x4*)g_mix + lane;
                f32x4 v[4]; float s = 0.f;
#pragma unroll
                for (int j = 0; j < 4; ++j) { v[j] = xr[64 * j]; s += (v[j].x * v[j].x + v[j].y * v[j].y) + (v[j].z * v[j].z + v[j].w * v[j].w); }
                const float rstd = 1.f / sqrtf(wave_sum(s) * (1.f / D) + RMS_EPS);
#pragma unroll
                for (int j = 0; j < 4; ++j) { const f32x4 gv = gr[64 * j]; const f32x4 o = {v[j].x * rstd * gv.x, v[j].y * rstd * gv.y, v[j].z * rstd * gv.z, v[j].w * rstd * gv.w};
                    *(LAS f32x4*)(um + r * 1024 + 4 * lane + 256 * j) = o; } }
            __syncthreads();
            const int colbase = (vcu < 16) ? 64 * vcu : (2048 + 64 * (vcu - 16));
            float acc[16];
#pragma unroll
            for (int r = 0; r < 16; ++r) acc[r] = 0.f;
            const int k0 = 128 * wave;
#pragma unroll 1
            for (int k = k0; k < k0 + 128; k += 4) {
                float wv[4];
#pragma unroll
                for (int kk = 0; kk < 4; ++kk) wv[kk] = w_in[(size_t)(k + kk) * NIN + colbase + lane];
#pragma unroll
                for (int r = 0; r < 16; ++r) { const f32x4 uv = *(const LAS f32x4*)(um + r * 1024 + k); acc[r] += uv.x * wv[0] + uv.y * wv[1] + uv.z * wv[2] + uv.w * wv[3]; }
            }
#pragma unroll
            for (int r = 0; r < 16; ++r) red[(wave * 16 + r) * 64 + lane] = acc[r];
            __syncthreads();
#pragma unroll 1
            for (int o = tid; o < 1024; o += NWAVES * 64) { const int r = o >> 6, c = o & 63; float s = 0.f;
#pragma unroll
                for (int w = 0; w < 8; ++w) s += red[(w * 16 + r) * 64 + c];
                const unsigned short hv = (unsigned short)f2bf(s);
                if (vcu < 16) ZPm[r * 1024 + 64 * vcu + c] = hv; else if (vcu < 20) Km[r * 256 + 64 * (vcu - 16) + c] = hv; else Vm[r * 256 + 64 * (vcu - 20) + c] = hv; }
            __syncthreads();
        }
        {
            LAS float* scr = (LAS float*)(lds + RING_OFF + wave * 16384);
            const int gw = vcu * NWAVES + wave, NGW = G * NWAVES;
            constexpr int I_IN = (D / 64) * (NIN / 32), I_PW = (256 / 64) * (256 / 32), I_SQ = (D / 64) * (D / 32), I_UP = (D / 64) * (FF / 32), I_DN = (FF / 64) * (D / 32);
            constexpr int NITEMS = I_IN + 4 * I_PW + 3 * I_SQ + I_UP + I_DN;
            for (int it = gw; it < NITEMS; it += NGW) {
                int r = it;
                if (r < I_IN) { p0_transpose_item(w_in, D, NIN, Win_t, 0, scr, r, lane); continue; } r -= I_IN;
                if (r < 4 * I_PW) { const int gi = r / I_PW; p0_transpose_item(pool_w + (size_t)gi * 65536, 256, 256, PW_t, 256 * gi, scr, r % I_PW, lane); continue; } r -= 4 * I_PW;
                if (r < I_SQ) { p0_transpose_item(w_pool_br, D, D, Wpb_t, 0, scr, r, lane); continue; } r -= I_SQ;
                if (r < I_SQ) { p0_transpose_item(w_attn_br, D, D, Wab_t, 0, scr, r, lane); continue; } r -= I_SQ;
                if (r < I_SQ) { p0_transpose_item(w_out, D, D, Wout_t, 0, scr, r, lane); continue; } r -= I_SQ;
                if (r < I_UP) { p0_transpose_item(w_up, D, FF, Wup_t, 0, scr, r, lane); continue; } r -= I_UP;
                p0_transpose_item(w_down, FF, D, Wdn_t, 0, scr, r, lane);
            }
            for (int m = gw; m < M; m += NGW) rms_row_to_bf16(lane, x + (size_t)m * D, g_mix, XN + (size_t)m * D);
        }
        if (BOTH(0)) GRID_BAR();
    }

    if (IN(1)) { PHASE_WS();
        pg8::Gemm g{XN, XN, Win_t, Win_t, D, D, D, 0}; pg8::StaticOrder S; S.init(M, NIN, G, bx);
        pg8::EpiInProj E{ZP, Qb, Kb, Vb, GP, GA, QSCALE};
        pg8::gemm_phase<pg8::EpiInProj, pg8::StaticOrder, true, true>(lds + RING_OFF, g, S, E);
        if (BOTH(1)) GRID_BAR();
    }

    if (IN(2)) { PHASE_WS();
        att::build_tab((LAS float*)(lds + TAB_OFF), rel_bias, tid);
        {
            const int cc = tid & 127, sub = tid >> 7, gg = cc >> 5, w = 2 << gg; const float invw = 1.0f / (float)w;
#pragma unroll 1
            for (int item = vcu; item < M / 64; item += G) {
                const int row0 = item * 64 + sub * 16, b = row0 >> 13, sst = row0 & (SEQ - 1);
                float acc[8];
#pragma unroll
                for (int e = 0; e < 8; ++e) acc[e] = 0.f;
#define ZROW(s) (((s) >= 0) ? (ZP + ((size_t)b * SEQ + (s)) * D + cc * 8) : (ZPm + (size_t)(16 + (s)) * D + cc * 8))
#define ACC8(op, v) do { acc[0] op bflo((v).x); acc[1] op bfhi((v).x); acc[2] op bflo((v).y); acc[3] op bfhi((v).y); acc[4] op bflo((v).z); acc[5] op bfhi((v).z); acc[6] op bflo((v).w); acc[7] op bfhi((v).w); } while (0)
#pragma unroll 1
                for (int i = 1; i < w; ++i) { const v4u v = *(const GAS v4u*)ZROW(sst - i); ACC8(+=, v); }
#pragma unroll 2
                for (int r = 0; r < 16; ++r) {
                    const int s = sst + r; const v4u z = *(const GAS v4u*)ZROW(s); const v4u zo = *(const GAS v4u*)ZROW(s - w + 1);
                    ACC8(+=, z);
                    v4u o; o.x = pk2(acc[0] * invw - bflo(z.x), acc[1] * invw - bfhi(z.x)); o.y = pk2(acc[2] * invw - bflo(z.y), acc[3] * invw - bfhi(z.y));
                    o.z = pk2(acc[4] * invw - bflo(z.z), acc[5] * invw - bfhi(z.z)); o.w = pk2(acc[6] * invw - bflo(z.w), acc[7] * invw - bfhi(z.w));
                    *(GAS v4u*)(POOLED + ((size_t)b * SEQ + s) * D + cc * 8) = o;
                    ACC8(-=, zo);
                }
#undef ZROW
#undef ACC8
            }
        }
        __syncthreads();
        for (int j = bx; j < BATCH * 64 * NKVH; j += G) { const int hkv = j & 3, n = (j >> 2) & 63, b = j >> 8;
            att::attn_unit(lds + RING_OFF, (const LAS float*)(lds + TAB_OFF), b, hkv, n, Qb, Kb, Vb, Km, Vm, Ob, rel_bias, sinks); }
        if (BOTH(2)) GRID_BAR();
    }

    if (IN(3)) { PHASE_WS();
        pg8::Gemm g{POOLED, POOLED, PW_t, PW_t, D, 256, 256, 256}; pg8::StaticOrder S; S.init(M, D, G, bx);
        pg8::EpiScaleCol E{MIXED, pool_scale};
        pg8::gemm_phase<pg8::EpiScaleCol, pg8::StaticOrder, true, true>(lds + RING_OFF, g, S, E);
        if (BOTH(3)) GRID_BAR();
    }

    if (IN(4)) { PHASE_WS();
        pg8::Gemm g{MIXED, Ob, Wpb_t, Wab_t, D, D, D, 0}; pg8::StaticOrder S; S.init(M, D, G, bx, 2);
        pg8::EpiBranch E{GP, GA, T1, MERGED};
        pg8::gemm_phase<pg8::EpiBranch, pg8::StaticOrder, true, true>(lds + RING_OFF, g, S, E);
        if (BOTH(4)) GRID_BAR();
    }

    if (IN(5)) { PHASE_WS();
        pg8::Gemm g{MERGED, MERGED, Wout_t, Wout_t, D, D, D, 0}; pg8::StaticOrder S; S.init(M, D, G, bx);
        pg8::EpiOutProj E{x, H1, U2, g_mlp, PART, M};
        pg8::gemm_phase<pg8::EpiOutProj, pg8::StaticOrder, true, true>(lds + RING_OFF, g, S, E);
        if (BOTH(5)) GRID_BAR();
    }

    if (IN(6)) { PHASE_WS();
        pg8::StaticOrder S; S.init(M, FF, G, bx);
        LAS float* rs = (LAS float*)(lds + TAB_OFF);
        { pg8::Unit u;
          for (int i = 0; i < 15 && S.next(i, u); ++i)
              for (int r = tid; r < 256; r += NWAVES * 64) { const int row = u.pm * 256 + r; float s = 0.f;
#pragma unroll
                  for (int j = 0; j < 16; ++j) s += PART[(size_t)j * M + row];
                  rs[i * 256 + r] = 1.f / sqrtf(s * (1.f / D) + RMS_EPS); } }
        __syncthreads();
        pg8::Gemm g{U2, U2, Wup_t, Wup_t, D, D, D, 0};
        pg8::EpiUp E{HID, rs};
        pg8::gemm_phase<pg8::EpiUp, pg8::StaticOrder, true, true>(lds + RING_OFF, g, S, E);
        if (BOTH(6)) GRID_BAR();
    }

    if (IN(7)) { PHASE_WS();
        pg8::Gemm g{HID, HID, Wdn_t, Wdn_t, FF, FF, FF, 0}; pg8::StaticOrder S; S.init(M, D, G, bx);
        pg8::EpiDown E{H1, out};
        pg8::gemm_phase<pg8::EpiDown, pg8::StaticOrder, true, true>(lds + RING_OFF, g, S, E);
        if (BOTH(7)) GRID_BAR();
    }

    if (IN(8)) { PHASE_WS();
        int lane8; asm volatile("v_mbcnt_lo_u32_b32 %0, -1, 0\n\tv_mbcnt_hi_u32_b32 %0, -1, %0" : "=v"(lane8));
        const int gw = vcu * NWAVES + wave, NGW = G * NWAVES;
        const GAS f32x4* gr = (const GAS f32x4*)g_final + lane8;
        f32x4 gv[4];
#pragma unroll
        for (int j = 0; j < 4; ++j) gv[j] = gr[64 * j];
#pragma unroll 1
        for (int m = gw; m < M; m += NGW) {
            GAS f32x4* xr = (GAS f32x4*)(out + (size_t)m * D) + lane8;
            f32x4 v[4]; float s = 0.f;
#pragma unroll
            for (int j = 0; j < 4; ++j) { v[j] = xr[64 * j]; s += (v[j].x * v[j].x + v[j].y * v[j].y) + (v[j].z * v[j].z + v[j].w * v[j].w); }
            const float rstd = 1.f / sqrtf(wave_sum(s) * (1.f / D) + RMS_EPS);
#pragma unroll
            for (int j = 0; j < 4; ++j) xr[64 * j] = (f32x4){v[j].x * rstd * gv[j].x, v[j].y * rstd * gv[j].y, v[j].z * rstd * gv[j].z, v[j].w * rstd * gv[j].w};
        }
    }
#undef IN
#undef BOTH
#undef GRID_BAR
}

extern "C" void kernel_launch(void* const* d_in, const int* in_sizes, int n_in, void* d_out, int out_size, void* d_ws, size_t ws_size, hipStream_t stream) {
    static int grid = 0;
    if (grid == 0) {
        if (n_in != 15 || in_sizes[0] != M * D || out_size != M * D || ws_size < WS_END) {
            fprintf(stderr, "kernel_launch: built for 15 inputs, x/out of %d floats, >= %zu bytes of workspace; got n_in %d, in0 %d, out %d, ws %zu\n", M * D, (size_t)WS_END, n_in, n_in > 0 ? in_sizes[0] : -1, out_size, ws_size);
            grid = -1; return; }
        int dev = 0, cus = 0, per_cu = 0;
        if (hipGetDevice(&dev) != hipSuccess || hipDeviceGetAttribute(&cus, hipDeviceAttributeMultiprocessorCount, dev) != hipSuccess) { fprintf(stderr, "kernel_launch: device query failed\n"); grid = -1; return; }
        if (hipFuncSetAttribute((const void*)fwd_megakernel, hipFuncAttributeMaxDynamicSharedMemorySize, LDS_BYTES) != hipSuccess) { fprintf(stderr, "kernel_launch: hipFuncSetAttribute failed\n"); grid = -1; return; }
        if (hipOccupancyMaxActiveBlocksPerMultiprocessor(&per_cu, (const void*)fwd_megakernel, NWAVES * 64, LDS_BYTES) != hipSuccess || per_cu < 1)
            fprintf(stderr, "kernel_launch: note: occupancy query reports %d workgroups per CU\n", per_cu);
        (void)hipGetLastError();
        grid = cus;
    }
    if (grid < 0) return;
    if (hipMemsetAsync((char*)d_ws + WS_CTL, 0, CTL_ZERO_BYTES, stream) != hipSuccess) { fprintf(stderr, "kernel_launch: hipMemsetAsync failed\n"); return; }
    Args a{};
    for (int i = 0; i < 15; ++i) a.in[i] = (const float*)d_in[i];
    a.out = (float*)d_out; a.ws = (unsigned char*)d_ws;
    for (int li = 0; li < N_LAUNCHES; ++li) {
        if (N_LAUNCHES == 1) { a.ph_lo = 0; a.ph_hi = N_PHASES; } else { a.ph_lo = li; a.ph_hi = li + 1; }
        a.li = li;
        hipLaunchKernelGGL(fwd_megakernel, dim3(grid), dim3(NWAVES * 64), LDS_BYTES, stream, a);
        const hipError_t le = hipPeekAtLastError();
        if (le != hipSuccess) { fprintf(stderr, "kernel_launch: launch %d failed: %s\n", li, hipGetErrorName(le)); break; }
    }
}
```
